# Optimizing an MI355X kernel written in HIP

```python
import functools
import jax, jax.numpy as jnp
from jax import lax
import numpy as np

D_MODEL = 1024
BATCH = 4
SEQ = 4096
DEPTH = 2
DEC_BATCH = 32
DEC_SEQ = 8
PAST_LEN = 8192
PAGE_SIZE = 128

CONV_DIM = D_MODEL // 4
CONV_GROUPS = 4
CONV_W = 3
HG_WIDTH = D_MODEL // 4
HG_HEADS = 4
HG_DK = HG_WIDTH // HG_HEADS
HG_DV = HG_WIDTH // HG_HEADS
HG_CHUNK = 64
ATT_WIDTH = D_MODEL // 2
HEAD_DIM = 64
N_HEADS = ATT_WIDTH // HEAD_DIM
N_KV = 4
KV_WIDTH = N_KV * HEAD_DIM
IDX_HEADS = 8
IDX_DIM = 32
TOPK_MAX = 256
Q_BLOCK = 128
MIX_WIDTH = CONV_DIM + HG_WIDTH + ATT_WIDTH
N_MEM = 256
X_HEADS = 4
X_HEAD_DIM = 128
X_WIDTH = X_HEADS * X_HEAD_DIM
D_FF = 4 * D_MODEL
ROPE_THETA = 10000.0
LN_EPS = 1e-5
DN_ALPHA = (2 * DEPTH) ** 0.25
DN_BETA = (8 * DEPTH) ** -0.25
SPLIT_SIZES = (CONV_DIM, CONV_DIM, CONV_DIM, HG_WIDTH, HG_WIDTH, HG_WIDTH, HG_WIDTH,
               ATT_WIDTH, KV_WIDTH, KV_WIDTH, IDX_HEADS * IDX_DIM, IDX_DIM, IDX_HEADS)
SPLIT_POINTS = tuple(int(s) for s in np.cumsum(SPLIT_SIZES)[:-1])
N_IN = sum(SPLIT_SIZES)

kernel_name = 'hymba_conv_hgrn2_dsa_deepnorm_step'

F32 = jnp.float32


def layer_norm(x, g, b):
    xf = x.astype(F32)
    mu = xf.mean(-1, keepdims=True)
    var = jnp.square(xf - mu).mean(-1, keepdims=True)
    return ((xf - mu) * lax.rsqrt(var + LN_EPS) * g.astype(F32) + b.astype(F32)).astype(x.dtype)


def rope(x, pos):
    half = x.shape[-1] // 2
    inv = ROPE_THETA ** (-jnp.arange(half, dtype=F32) / half)
    ang = pos.astype(F32)[:, None] * inv[None, :]
    cos, sin = jnp.cos(ang)[:, None, :], jnp.sin(ang)[:, None, :]
    x1, x2 = x[..., :half].astype(F32), x[..., half:].astype(F32)
    return jnp.concatenate([x1 * cos - x2 * sin, x2 * cos + x1 * sin], axis=-1).astype(x.dtype)


def short_gated_conv(h, bg, cg, w_conv, buf):
    u = cg * h
    ext = jnp.concatenate([buf.astype(u.dtype), u], axis=1)
    L = u.shape[1]
    y = sum(w_conv[j] * ext[:, j:j + L] for j in range(CONV_W))
    return bg * y, ext[:, ext.shape[1] - (CONV_W - 1):]


def hgrn_lower_bounds(logits):
    p = jax.nn.softmax(logits.astype(F32), axis=0)
    c = jnp.cumsum(p, axis=0)
    return c - c[0:1]


def hgrn2_chunked(q, k, v, logf, s0):
    B, L, H, DK = q.shape
    C = HG_CHUNK if L % HG_CHUNK == 0 else L
    n = L // C
    def chunks(a):
        return a.reshape(B, n, C, H, a.shape[-1]).transpose(1, 0, 3, 2, 4).astype(F32)
    causal = jnp.tril(jnp.ones((C, C), bool))[:, :, None]
    def step(S, inp):
        qi, ki, vi, gi = inp
        b = jnp.cumsum(gi, axis=2)
        inter = jnp.einsum('bhtk,bhkv->bhtv', qi * jnp.exp(b), S)
        diff = b[:, :, :, None, :] - b[:, :, None, :, :]
        decay = jnp.exp(jnp.where(causal, diff, -jnp.inf))
        att = jnp.einsum('bhtk,bhtsk,bhsk->bhts', qi, decay, ki)
        intra = jnp.einsum('bhts,bhsv->bhtv', att, vi)
        bC = b[:, :, -1:, :]
        S_new = jnp.exp(bC[:, :, 0, :])[..., None] * S + jnp.einsum('bhsk,bhsv->bhkv', ki * jnp.exp(bC - b), vi)
        return S_new, inter + intra
    S, o = lax.scan(step, s0.astype(F32), (chunks(q), chunks(k), chunks(v), chunks(logf)))
    o = o.transpose(1, 0, 3, 2, 4).reshape(B, L, H, v.shape[-1])
    return o, S


def index_scores(qi, ki, wi):
    dots = jnp.einsum('bthd,bsd->bths', qi.astype(F32), ki.astype(F32))
    return jnp.einsum('bth,bths->bts', wi.astype(F32), jax.nn.relu(dots))


def sparse_attend(q, kg, vg, ok):
    B, T = q.shape[:2]
    qg = q.reshape(B, T, N_KV, N_HEADS // N_KV, HEAD_DIM).astype(F32)
    s = jnp.einsum('btngd,btknd->btngk', qg, kg.astype(F32)) * (HEAD_DIM ** -0.5)
    s = jnp.where(ok[:, :, None, None, :], s, -jnp.inf)
    p = jax.nn.softmax(s, axis=-1)
    o = jnp.einsum('btngk,btknd->btngd', p, vg.astype(F32))
    return o.reshape(B, T, N_HEADS, HEAD_DIM).astype(q.dtype)


def take_rows(a, idx):
    return jax.vmap(lambda aa, ii: aa[ii])(a, idx)


def dsa_prompt(q, k, v, qi, ki, wi):
    B, T = q.shape[:2]
    ksel = min(TOPK_MAX, T // 4)
    key_pos = jnp.arange(T)
    def block(i):
        t0 = i * Q_BLOCK
        sl = lambda a: lax.dynamic_slice_in_dim(a, t0, Q_BLOCK, axis=1)
        qpos = t0 + jnp.arange(Q_BLOCK)
        score = index_scores(sl(qi), ki, sl(wi))
        score = jnp.where(key_pos[None, None, :] <= qpos[None, :, None], score, -jnp.inf)
        _, idx = lax.top_k(score, ksel)
        ok = idx <= qpos[None, :, None]
        return sparse_attend(sl(q), take_rows(k, idx), take_rows(v, idx), ok)
    out = lax.map(block, jnp.arange(T // Q_BLOCK))
    return jnp.moveaxis(out, 0, 1).reshape(B, T, N_HEADS, HEAD_DIM)


def dsa_sample(q, k, v, qi, ki, wi, cache_k, cache_v, cache_kidx, page_table, layer):
    DB, T = q.shape[:2]
    page = cache_k.shape[2]
    past = page_table.shape[1] * page
    L = past + T
    ksel = min(TOPK_MAX, L // 4)
    ki_past = cache_kidx[layer, page_table].reshape(DB, past, IDX_DIM)
    ki_all = jnp.concatenate([ki_past.astype(ki.dtype), ki], axis=1)
    qpos = past + jnp.arange(T)
    score = index_scores(qi, ki_all, wi)
    score = jnp.where(jnp.arange(L)[None, None, :] <= qpos[None, :, None], score, -jnp.inf)
    _, idx = lax.top_k(score, ksel)
    ok = idx <= qpos[None, :, None]
    is_new = (idx >= past)[..., None, None]
    pidx = jnp.minimum(idx, past - 1)
    phys = jax.vmap(lambda pt, j: pt[j])(page_table, pidx // page)
    off = pidx % page
    nidx = jnp.clip(idx - past, 0, T - 1)
    kg = jnp.where(is_new, take_rows(k, nidx), cache_k[layer, phys, off].astype(k.dtype))
    vg = jnp.where(is_new, take_rows(v, nidx), cache_v[layer, phys, off].astype(v.dtype))
    return sparse_attend(q, kg, vg, ok)


def token_mixer(x, pos, w_in_l, w_conv_l, lb_l, hg_norm_l, w_out_l, conv_buf, hg_s0, attend):
    B, L, _ = x.shape
    z = x @ w_in_l
    (c_h, c_b, c_c, g_q, g_f, g_i, g_g, a_q, a_k, a_v, a_qi, a_ki, a_w) = jnp.split(z, SPLIT_POINTS, axis=-1)
    y_conv, conv_state = short_gated_conv(c_h, c_b, c_c, w_conv_l, conv_buf)
    sig = jax.nn.sigmoid(g_f.astype(F32))
    f = lb_l + (1.0 - lb_l) * sig
    kk = (1.0 - lb_l) * (1.0 - sig)
    heads = lambda a: a.reshape(B, L, HG_HEADS, a.shape[-1] // HG_HEADS)
    o_hg, hg_state = hgrn2_chunked(heads(g_q), heads(kk), heads(g_i), heads(jnp.log(f)), hg_s0)
    o_hg = o_hg * lax.rsqrt(jnp.mean(jnp.square(o_hg), -1, keepdims=True) + LN_EPS)
    o_hg = o_hg * hg_norm_l.astype(F32).reshape(HG_HEADS, HG_DV)
    y_hg = (o_hg.reshape(B, L, HG_WIDTH) * jax.nn.sigmoid(g_g.astype(F32))).astype(x.dtype)
    q = rope(a_q.reshape(B, L, N_HEADS, HEAD_DIM), pos)
    k = rope(a_k.reshape(B, L, N_KV, HEAD_DIM), pos)
    v = a_v.reshape(B, L, N_KV, HEAD_DIM)
    qi = rope(a_qi.reshape(B, L, IDX_HEADS, IDX_DIM), pos) * (IDX_DIM ** -0.5)
    ki = rope(a_ki[:, :, None, :], pos)[:, :, 0, :]
    wi = a_w * (IDX_HEADS ** -0.5)
    y_att = attend(q, k, v, qi, ki, wi).reshape(B, L, ATT_WIDTH)
    y = jnp.concatenate([y_conv, y_hg, y_att.astype(x.dtype)], axis=-1) @ w_out_l
    return y, conv_state, hg_state, k, v, ki


def cross_and_ffn(h, mk, mv, w_xq_l, w_xo_l, g2, b2, w_up_l, w_down_l, g3, b3):
    B, T, _ = h.shape
    q = (h @ w_xq_l).reshape(B, T, X_HEADS, X_HEAD_DIM)
    s = jnp.einsum('bthd,bmhd->bhtm', q.astype(F32), mk.astype(F32)) * (X_HEAD_DIM ** -0.5)
    p = jax.nn.softmax(s, axis=-1)
    o = jnp.einsum('bhtm,bmhd->bthd', p, mv.astype(F32)).reshape(B, T, X_WIDTH).astype(h.dtype)
    h = layer_norm(DN_ALPHA * h + o @ w_xo_l, g2, b2)
    u = jax.nn.relu(h @ w_up_l)
    return layer_norm(DN_ALPHA * h + (u * u) @ w_down_l, g3, b3)


def setup_inputs(seed: int = 0) -> dict:
    key = jax.random.key(seed)
    ks = iter(jax.random.split(key, 40))
    nrm = lambda shape, scale=1.0: jax.random.normal(next(ks), shape, F32) * scale
    n_pages = PAST_LEN // PAGE_SIZE
    n_phys = (DEC_BATCH * n_pages * 5) // 4
    page_table = jax.random.permutation(next(ks), n_phys)[:DEC_BATCH * n_pages]
    page_table = page_table.reshape(DEC_BATCH, n_pages).astype(jnp.int32)
    return {
        'x_prompt': nrm((BATCH, SEQ, D_MODEL)),
        'x_sample': nrm((DEC_BATCH, DEC_SEQ, D_MODEL)),
        'cache_k': nrm((DEPTH, n_phys, PAGE_SIZE, N_KV, HEAD_DIM)),
        'cache_v': nrm((DEPTH, n_phys, PAGE_SIZE, N_KV, HEAD_DIM)),
        'cache_kidx': nrm((DEPTH, n_phys, PAGE_SIZE, IDX_DIM)),
        'state_hgrn': nrm((DEPTH, DEC_BATCH, HG_HEADS, HG_DK, HG_DV), 0.5),
        'state_conv': nrm((DEPTH, DEC_BATCH, CONV_W - 1, CONV_DIM)),
        'cache_mem_k': nrm((DEPTH, DEC_BATCH, N_MEM, X_HEADS, X_HEAD_DIM)),
        'cache_mem_v': nrm((DEPTH, DEC_BATCH, N_MEM, X_HEADS, X_HEAD_DIM)),
        'page_table': page_table,
        'mem_prompt': nrm((BATCH, N_MEM, D_MODEL)),
        'w_in': nrm((DEPTH, D_MODEL, N_IN), D_MODEL ** -0.5),
        'w_conv': nrm((DEPTH, CONV_W, CONV_DIM), CONV_W ** -0.5),
        'hg_lb_logits': nrm((DEPTH, HG_WIDTH), 0.5),
        'hg_norm': 1.0 + nrm((DEPTH, HG_WIDTH), 0.02),
        'w_out': nrm((DEPTH, MIX_WIDTH, D_MODEL), DN_BETA * MIX_WIDTH ** -0.5),
        'ln1_g': 1.0 + nrm((DEPTH, D_MODEL), 0.02),
        'ln1_b': nrm((DEPTH, D_MODEL), 0.02),
        'w_xq': nrm((DEPTH, D_MODEL, X_WIDTH), D_MODEL ** -0.5),
        'w_xk': nrm((DEPTH, D_MODEL, X_WIDTH), D_MODEL ** -0.5),
        'w_xv': nrm((DEPTH, D_MODEL, X_WIDTH), D_MODEL ** -0.5),
        'w_xo': nrm((DEPTH, X_WIDTH, D_MODEL), DN_BETA * X_WIDTH ** -0.5),
        'ln2_g': 1.0 + nrm((DEPTH, D_MODEL), 0.02),
        'ln2_b': nrm((DEPTH, D_MODEL), 0.02),
        'w_up': nrm((DEPTH, D_MODEL, D_FF), D_MODEL ** -0.5),
        'w_down': nrm((DEPTH, D_FF, D_MODEL), DN_BETA * D_FF ** -0.5),
        'ln3_g': 1.0 + nrm((DEPTH, D_MODEL), 0.02),
        'ln3_b': nrm((DEPTH, D_MODEL), 0.02),
    }


def reference(x_prompt, x_sample, cache_k, cache_v, cache_kidx, state_hgrn, state_conv, cache_mem_k, cache_mem_v,
              page_table, mem_prompt, w_in, w_conv, hg_lb_logits, hg_norm, w_out, ln1_g, ln1_b,
              w_xq, w_xk, w_xv, w_xo, ln2_g, ln2_b, w_up, w_down, ln3_g, ln3_b):
    Bp, Tp, _ = x_prompt.shape
    past = page_table.shape[1] * cache_k.shape[2]
    pos_p = jnp.arange(Tp)
    pos_s = past + jnp.arange(x_sample.shape[1])
    lower = hgrn_lower_bounds(hg_lb_logits)
    hp, hs = x_prompt, x_sample
    kp, vp, kip, ksl, vsl, kis, hgp, hgs, cvp, cvs, mkp, mvp = ([] for _ in range(12))
    for l in range(DEPTH):
        mixer_w = (w_in[l], w_conv[l], lower[l], hg_norm[l], w_out[l])
        tail_w = (w_xq[l], w_xo[l], ln2_g[l], ln2_b[l], w_up[l], w_down[l], ln3_g[l], ln3_b[l])
        conv0 = jnp.zeros((Bp, CONV_W - 1, CONV_DIM), hp.dtype)
        hg0 = jnp.zeros((Bp, HG_HEADS, HG_DK, HG_DV), F32)
        y, c_st, h_st, k, v, ki = token_mixer(hp, pos_p, *mixer_w, conv0, hg0, dsa_prompt)
        hp = layer_norm(DN_ALPHA * hp + y, ln1_g[l], ln1_b[l])
        mk = (mem_prompt @ w_xk[l]).reshape(Bp, N_MEM, X_HEADS, X_HEAD_DIM)
        mv = (mem_prompt @ w_xv[l]).reshape(Bp, N_MEM, X_HEADS, X_HEAD_DIM)
        hp = cross_and_ffn(hp, mk, mv, *tail_w)
        kp.append(k); vp.append(v); kip.append(ki); hgp.append(h_st); cvp.append(c_st); mkp.append(mk); mvp.append(mv)
        attend = functools.partial(dsa_sample, cache_k=cache_k, cache_v=cache_v, cache_kidx=cache_kidx,
                                   page_table=page_table, layer=l)
        y, c_st, h_st, k, v, ki = token_mixer(hs, pos_s, *mixer_w, state_conv[l], state_hgrn[l], attend)
        hs = layer_norm(DN_ALPHA * hs + y, ln1_g[l], ln1_b[l])
        hs = cross_and_ffn(hs, cache_mem_k[l], cache_mem_v[l], *tail_w)
        ksl.append(k); vsl.append(v); kis.append(ki); hgs.append(h_st); cvs.append(c_st)
    st = lambda xs: jnp.stack(xs, axis=0)
    return (hp, hs, st(kp), st(vp), st(kip), st(ksl), st(vsl), st(kis),
            st(hgp), st(hgs), st(cvp), st(cvs), st(mkp), st(mvp))
```

```cpp
#include <hip/hip_runtime.h>
#include <cstdio>
#include <cstring>
#include <cmath>
#include <cstdint>
#include <cstddef>
#ifdef HOST_SIM
#define HD inline
#else
#define HD __device__ __forceinline__
#endif

#ifndef CFG_BATCH
#define CFG_BATCH 4
#endif
#ifndef CFG_SEQ
#define CFG_SEQ 4096
#endif
#ifndef CFG_DEC_BATCH
#define CFG_DEC_BATCH 32
#endif
#ifndef CFG_PAST
#define CFG_PAST 8192
#endif
namespace nb {
constexpr int D = 1024, DEPTH = 2, BATCH = CFG_BATCH, SEQ = CFG_SEQ, DEC_BATCH = CFG_DEC_BATCH, DEC_SEQ = 8, PAST = CFG_PAST, PAGE = 128;
constexpr int NPAGES = PAST / PAGE, NPHYS = (DEC_BATCH * NPAGES * 5) / 4;
constexpr int CONVD = 256, HGW = 256, HGH = 4, HDK = 64, ATTW = 512, HD_ = 64, NH = 8, NKV = 4, KVW = 256, IH = 8, IDD = 32, TOPK = 256;
constexpr int NIN = 3112;
constexpr int C_H = 0, C_B = 256, C_C = 512, G_Q = 768, G_F = 1024, G_I = 1280, G_G = 1536, A_Q = 1792, A_K = 2304, A_V = 2560, A_QI = 2816, A_KI = 3072, A_W = 3104;
constexpr int NMEM = 256, XH = 4, XHD = 128, XW = 512, DFF = 4096;
constexpr int MP = BATCH * SEQ, MS = DEC_BATCH * DEC_SEQ;
constexpr int KSEL_P = (SEQ / 4 < TOPK) ? SEQ / 4 : TOPK;
constexpr int KSEL_S = ((PAST + DEC_SEQ) / 4 < TOPK) ? (PAST + DEC_SEQ) / 4 : TOPK;
constexpr float LN_EPS = 1e-5f;
constexpr float DN_ALPHA = 1.41421356237309515f;
constexpr size_t O_YP = 0, O_YS = O_YP + (size_t)MP * D, O_KP = O_YS + (size_t)MS * D, O_VP = O_KP + (size_t)DEPTH * MP * KVW, O_KIP = O_VP + (size_t)DEPTH * MP * KVW,
                 O_KS = O_KIP + (size_t)DEPTH * MP * IDD, O_VS = O_KS + (size_t)DEPTH * MS * KVW, O_KIS = O_VS + (size_t)DEPTH * MS * KVW,
                 O_HGP = O_KIS + (size_t)DEPTH * MS * IDD, O_HGS = O_HGP + (size_t)DEPTH * BATCH * HGH * 4096, O_CVP = O_HGS + (size_t)DEPTH * DEC_BATCH * HGH * 4096,
                 O_CVS = O_CVP + (size_t)DEPTH * BATCH * 2 * CONVD, O_MKP = O_CVS + (size_t)DEPTH * DEC_BATCH * 2 * CONVD, O_MVP = O_MKP + (size_t)DEPTH * BATCH * NMEM * XW,
                 O_END = O_MVP + (size_t)DEPTH * BATCH * NMEM * XW;

struct Grp {
    int NB, L, M, pos0, ksel, is_sample, layer, LK;
    const float* X;
    float* Z;
    float* F;
    float* KK;
    float* AQ;
    float* AK;
    float* AV;
    float* QI;
    float* KI;
    float* WI;
    float* OHG;
    float* YCAT;
    float* SC;
    float* THR; int* TIDX; int* SEL; int* NSEL;
    float* P;
    float* Y;
    float* H1; float* H2; float* XO;
    float* QX;
    float* PX;
    float* OX;
    float* UU;
    const float* MK; const float* MV;
    float* hg_state_out; const float* hg_state_in;
    float* conv_out; const float* conv_in;
    const float *cache_k, *cache_v, *cache_kidx; const int* page_table;
    const float* rope_c; const float* rope_s;
    const float *w_conv, *lb, *hg_norm, *ln1g, *ln1b, *ln2g, *ln2b, *ln3g, *ln3b;
};

HD float sigmoidf_(float x) { return 1.0f / (1.0f + expf(-x)); }

struct GemmEl { const float* A; const float* W; float* C; int M, N, K; int act;
    HD void operator()(long i) const { const int row = (int)(i / N), col = (int)(i % N); const float* a = A + (size_t)row * K; float acc = 0.f;
        for (int k = 0; k < K; ++k) acc = fmaf(a[k], W[(size_t)k * N + col], acc);
        if (act == 1) { acc = acc > 0.f ? acc : 0.f; acc = acc * acc; }
        C[(size_t)row * N + col] = acc; } };

struct RopeTab { float* c; float* s;
    HD void operator()(long i) const { const int p = (int)(i / 32), j = (int)(i % 32); const double pos = p < SEQ ? (double)p : (double)(PAST + (p - SEQ));
        const double inv = pow(10000.0, -(double)j / 32.0), ang = pos * inv; c[i] = (float)cos(ang); s[i] = (float)sin(ang); } };

struct LowerB { const float* logits; float* lb;
    HD void operator()(long i) const { const int c = (int)i; const float l0 = logits[c], l1 = logits[256 + c]; const float m = l0 > l1 ? l0 : l1;
        const float e0 = expf(l0 - m), e1 = expf(l1 - m); lb[c] = 0.f; lb[256 + c] = e1 / (e0 + e1); } };

struct PostConv { Grp g;
    HD float u(int b, int t, int c) const { if (t >= 0) { const float* z = g.Z + (size_t)(b * g.L + t) * NIN; return z[C_C + c] * z[C_H + c]; }
        return g.conv_in ? g.conv_in[((size_t)b * 2 + (t + 2)) * CONVD + c] : 0.f; }
    HD void operator()(long i) const { const int row = (int)(i / CONVD), c = (int)(i % CONVD), b = row / g.L, t = row % g.L;
        const float y = g.w_conv[0 * CONVD + c] * u(b, t - 2, c) + g.w_conv[1 * CONVD + c] * u(b, t - 1, c) + g.w_conv[2 * CONVD + c] * u(b, t, c);
        g.YCAT[(size_t)row * D + c] = g.Z[(size_t)row * NIN + C_B + c] * y;
        if (t >= g.L - 2) g.conv_out[((size_t)b * 2 + (t - (g.L - 2))) * CONVD + c] = u(b, t, c); } };

struct PostGate { Grp g;
    HD void operator()(long i) const { const int row = (int)(i / HGW), c = (int)(i % HGW); const float sg = sigmoidf_(g.Z[(size_t)row * NIN + G_F + c]); const float lb = g.lb[c];
        g.F[i] = lb + (1.f - lb) * sg; g.KK[i] = (1.f - lb) * (1.f - sg); } };

struct PostRope { Grp g;
    HD void operator()(long i) const { const int row = (int)(i / 792); int p = (int)(i % 792); const int t = row % g.L; const float* z = g.Z + (size_t)row * NIN;
        const float* rc = g.rope_c + (size_t)((g.is_sample ? SEQ : 0) + t) * 32; const float* rs = g.rope_s + (size_t)((g.is_sample ? SEQ : 0) + t) * 32;
        if (p < 256) { const int h = p / 32, j = p % 32; const float x1 = z[A_Q + h * 64 + j], x2 = z[A_Q + h * 64 + 32 + j], c = rc[j], s = rs[j];
            g.AQ[(size_t)row * 512 + h * 64 + j] = x1 * c - x2 * s; g.AQ[(size_t)row * 512 + h * 64 + 32 + j] = x2 * c + x1 * s; return; } p -= 256;
        if (p < 128) { const int h = p / 32, j = p % 32; const float x1 = z[A_K + h * 64 + j], x2 = z[A_K + h * 64 + 32 + j], c = rc[j], s = rs[j];
            g.AK[(size_t)row * 256 + h * 64 + j] = x1 * c - x2 * s; g.AK[(size_t)row * 256 + h * 64 + 32 + j] = x2 * c + x1 * s; return; } p -= 128;
        if (p < 256) { g.AV[(size_t)row * 256 + p] = z[A_V + p]; return; } p -= 256;
        if (p < 128) { const int h = p / 16, j = p % 16; const float x1 = z[A_QI + h * 32 + j], x2 = z[A_QI + h * 32 + 16 + j], c = rc[2 * j], s = rs[2 * j]; const float sc = 0.17677669529663687f;
            g.QI[(size_t)row * 256 + h * 32 + j] = (x1 * c - x2 * s) * sc; g.QI[(size_t)row * 256 + h * 32 + 16 + j] = (x2 * c + x1 * s) * sc; return; } p -= 128;
        if (p < 16) { const int j = p; const float x1 = z[A_KI + j], x2 = z[A_KI + 16 + j], c = rc[2 * j], s = rs[2 * j];
            g.KI[(size_t)row * 32 + j] = x1 * c - x2 * s; g.KI[(size_t)row * 32 + 16 + j] = x2 * c + x1 * s; return; } p -= 16;
        g.WI[(size_t)row * 8 + p] = z[A_W + p] * 0.35355339059327373f; } };

struct HgrnSeq { Grp g;
    HD void operator()(long i) const { const int v = (int)(i % 64), h = (int)((i / 64) % HGH), b = (int)(i / (64 * HGH)); float S[64];
#pragma unroll
        for (int k = 0; k < 64; ++k) S[k] = g.hg_state_in ? g.hg_state_in[(((size_t)b * HGH + h) * 64 + k) * 64 + v] : 0.f;
        for (int t = 0; t < g.L; ++t) { const size_t row = (size_t)b * g.L + t; const float* z = g.Z + row * NIN; const float* f = g.F + row * HGW + h * 64; const float* kk = g.KK + row * HGW + h * 64; const float vv = z[G_I + h * 64 + v]; float o = 0.f;
#pragma unroll
            for (int k = 0; k < 64; ++k) { S[k] = f[k] * S[k] + kk[k] * vv; o = fmaf(z[G_Q + h * 64 + k], S[k], o); }
            g.OHG[row * HGW + h * 64 + v] = o; }
#pragma unroll
        for (int k = 0; k < 64; ++k) g.hg_state_out[(((size_t)b * HGH + h) * 64 + k) * 64 + v] = S[k]; } };

struct HgrnNorm { Grp g;
    HD void operator()(long i) const { const int row = (int)(i / HGW), c = (int)(i % HGW), h = c / 64; const float* o = g.OHG + (size_t)row * HGW + h * 64; float ss = 0.f;
        for (int k = 0; k < 64; ++k) ss = fmaf(o[k], o[k], ss);
        const float r = 1.0f / sqrtf(ss * (1.f / 64.f) + LN_EPS);
        g.YCAT[(size_t)row * D + 256 + c] = o[c % 64] * r * g.hg_norm[c] * sigmoidf_(g.Z[(size_t)row * NIN + G_G + c]); } };

HD const float* ki_row(const Grp& g, int b, int s) {
    if (!g.is_sample) return g.KI + ((size_t)b * g.L + s) * IDD;
    if (s < PAST) { const int pg = g.page_table[b * NPAGES + s / PAGE]; return g.cache_kidx + ((size_t)pg * PAGE + s % PAGE) * IDD; }
    return g.KI + ((size_t)b * g.L + (s - PAST)) * IDD; }
HD const float* k_row(const Grp& g, int b, int s) {
    if (!g.is_sample) return g.AK + ((size_t)b * g.L + s) * KVW;
    if (s < PAST) { const int pg = g.page_table[b * NPAGES + s / PAGE]; return g.cache_k + ((size_t)pg * PAGE + s % PAGE) * KVW; }
    return g.AK + ((size_t)b * g.L + (s - PAST)) * KVW; }
HD const float* v_row(const Grp& g, int b, int s) {
    if (!g.is_sample) return g.AV + ((size_t)b * g.L + s) * KVW;
    if (s < PAST) { const int pg = g.page_table[b * NPAGES + s / PAGE]; return g.cache_v + ((size_t)pg * PAGE + s % PAGE) * KVW; }
    return g.AV + ((size_t)b * g.L + (s - PAST)) * KVW; }

struct IdxScore { Grp g;
    HD void operator()(long i) const { const int row = (int)(i / g.LK), s = (int)(i % g.LK), b = row / g.L, t = row % g.L; const int qpos = g.pos0 + t;
        if (s > qpos) return;
        const float* k = ki_row(g, b, s); const float* q = g.QI + (size_t)row * 256; const float* w = g.WI + (size_t)row * 8; float sc = 0.f;
        for (int h = 0; h < IH; ++h) { float d = 0.f; for (int e = 0; e < IDD; ++e) d = fmaf(q[h * IDD + e], k[e], d); sc = fmaf(w[h], d > 0.f ? d : 0.f, sc); }
        g.SC[(size_t)row * g.LK + s] = sc; } };

HD unsigned fkey(float x) { unsigned u; if (x == 0.f) x = 0.f;
#ifdef HOST_SIM
    __builtin_memcpy(&u, &x, 4);
#else
    u = __float_as_uint(x);
#endif
    if (u == 0x80000000u) u = 0u; return (u & 0x80000000u) ? ~u : (u | 0x80000000u); }
HD float fkey_inv(unsigned k) { unsigned u = (k & 0x80000000u) ? (k & 0x7fffffffu) : ~k; float x;
#ifdef HOST_SIM
    __builtin_memcpy(&x, &u, 4);
#else
    x = __uint_as_float(u);
#endif
    return x; }

struct TopK { Grp g;
    HD void operator()(long i) const { const int row = (int)i, t = row % g.L; const int nv = g.pos0 + t + 1; const float* sc = g.SC + (size_t)row * g.LK; int* sel = g.SEL + (size_t)row * TOPK;
        if (nv <= g.ksel) { for (int s = 0; s < nv; ++s) sel[s] = s; g.NSEL[row] = nv; return; }
        unsigned K = 0u;
        for (int bit = 31; bit >= 0; --bit) { const unsigned cand = K | (1u << bit); int cnt = 0; for (int s = 0; s < nv; ++s) cnt += (fkey(sc[s]) >= cand) ? 1 : 0; if (cnt >= g.ksel) K = cand; }
        int cgt = 0; for (int s = 0; s < nv; ++s) cgt += (fkey(sc[s]) > K) ? 1 : 0;
        int r = g.ksel - cgt, n = 0;
        for (int s = 0; s < nv; ++s) { const unsigned k = fkey(sc[s]); if (k > K) sel[n++] = s; else if (k == K && r > 0) { sel[n++] = s; --r; } }
        g.NSEL[row] = n; } };

struct AttProb { Grp g;
    HD void operator()(long i) const { const int row = (int)(i / NH), h = (int)(i % NH), b = row / g.L, n = h / 2; const int ns = g.NSEL[row]; const int* sel = g.SEL + (size_t)row * TOPK;
        float* p = g.P + ((size_t)row * NH + h) * TOPK; const float* q = g.AQ + (size_t)row * 512 + h * 64; float mx = -INFINITY;
        for (int j = 0; j < ns; ++j) { const float* k = k_row(g, b, sel[j]) + n * 64; float d = 0.f; for (int e = 0; e < 64; ++e) d = fmaf(q[e], k[e], d); d *= 0.125f; p[j] = d; mx = d > mx ? d : mx; }
        float sum = 0.f; for (int j = 0; j < ns; ++j) { const float e = expf(p[j] - mx); p[j] = e; sum += e; }
        const float inv = 1.f / sum; for (int j = 0; j < ns; ++j) p[j] *= inv; } };

struct AttOut { Grp g;
    HD void operator()(long i) const { const int row = (int)(i / 512), c = (int)(i % 512), h = c / 64, d = c % 64, b = row / g.L, n = h / 2; const int ns = g.NSEL[row]; const int* sel = g.SEL + (size_t)row * TOPK;
        const float* p = g.P + ((size_t)row * NH + h) * TOPK; float o = 0.f;
        for (int j = 0; j < ns; ++j) o = fmaf(p[j], v_row(g, b, sel[j])[n * 64 + d], o);
        g.YCAT[(size_t)row * D + 512 + c] = o; } };

struct LnRes { const float* base; const float* y; const float* gam; const float* bet; float* out; int M, pad;
    HD void operator()(long i) const { const size_t o = (size_t)i * D; float s = 0.f; for (int c = 0; c < D; ++c) s += DN_ALPHA * base[o + c] + y[o + c];
        const float mu = s * (1.f / D); float q = 0.f; for (int c = 0; c < D; ++c) { const float d = DN_ALPHA * base[o + c] + y[o + c] - mu; q = fmaf(d, d, q); }
        const float r = 1.0f / sqrtf(q * (1.f / D) + LN_EPS); for (int c = 0; c < D; ++c) out[o + c] = (DN_ALPHA * base[o + c] + y[o + c] - mu) * r * gam[c] + bet[c]; } };

struct XProb { Grp g;
    HD void operator()(long i) const { const int row = (int)(i / XH), h = (int)(i % XH), b = row / g.L; const float* q = g.QX + (size_t)row * XW + h * XHD; float* p = g.PX + ((size_t)row * XH + h) * NMEM; float mx = -INFINITY;
        for (int m = 0; m < NMEM; ++m) { const float* k = g.MK + ((size_t)b * NMEM + m) * XW + h * XHD; float d = 0.f; for (int e = 0; e < XHD; ++e) d = fmaf(q[e], k[e], d); d *= 0.08838834764831845f; p[m] = d; mx = d > mx ? d : mx; }
        float sum = 0.f; for (int m = 0; m < NMEM; ++m) { const float e = expf(p[m] - mx); p[m] = e; sum += e; }
        const float inv = 1.f / sum; for (int m = 0; m < NMEM; ++m) p[m] *= inv; } };

struct XOut { Grp g;
    HD void operator()(long i) const { const int row = (int)(i / XW), c = (int)(i % XW), h = c / XHD, b = row / g.L; const float* p = g.PX + ((size_t)row * XH + h) * NMEM; float o = 0.f;
        for (int m = 0; m < NMEM; ++m) o = fmaf(p[m], g.MV[((size_t)b * NMEM + m) * XW + c], o);
        g.OX[(size_t)row * XW + c] = o; } };

struct CopyF { const float* src; float* dst; HD void operator()(long i) const { dst[i] = src[i]; } };
}
#include <cstring>
namespace nb {
struct Bump { char* p; size_t used; void* take(size_t bytes) { void* r = p + used; used += (bytes + 255) & ~(size_t)255; return r; } };

template <class Runner>
void forward(Runner& R, void* const* d_in, float* out, void* ws, size_t ws_size) {
    const float* x_prompt = (const float*)d_in[0]; const float* x_sample = (const float*)d_in[1];
    const float* cache_k = (const float*)d_in[2]; const float* cache_v = (const float*)d_in[3]; const float* cache_kidx = (const float*)d_in[4];
    const float* state_hgrn = (const float*)d_in[5]; const float* state_conv = (const float*)d_in[6];
    const float* cache_mem_k = (const float*)d_in[7]; const float* cache_mem_v = (const float*)d_in[8];
    const int* page_table = (const int*)d_in[9]; const float* mem_prompt = (const float*)d_in[10];
    const float* w_in = (const float*)d_in[11]; const float* w_conv = (const float*)d_in[12]; const float* hg_lb_logits = (const float*)d_in[13]; const float* hg_norm = (const float*)d_in[14];
    const float* w_out = (const float*)d_in[15]; const float* ln1_g = (const float*)d_in[16]; const float* ln1_b = (const float*)d_in[17];
    const float* w_xq = (const float*)d_in[18]; const float* w_xk = (const float*)d_in[19]; const float* w_xv = (const float*)d_in[20]; const float* w_xo = (const float*)d_in[21];
    const float* ln2_g = (const float*)d_in[22]; const float* ln2_b = (const float*)d_in[23]; const float* w_up = (const float*)d_in[24]; const float* w_down = (const float*)d_in[25];
    const float* ln3_g = (const float*)d_in[26]; const float* ln3_b = (const float*)d_in[27];

    Bump B{(char*)ws, 0};
    float* rope_c = (float*)B.take((size_t)(SEQ + 8) * 32 * 4); float* rope_s = (float*)B.take((size_t)(SEQ + 8) * 32 * 4);
    float* lb = (float*)B.take(DEPTH * 256 * 4);
    Grp G[2]; memset(G, 0, sizeof(G));
    for (int gi = 0; gi < 2; ++gi) { Grp& g = G[gi]; g.is_sample = gi; g.NB = gi ? DEC_BATCH : BATCH; g.L = gi ? DEC_SEQ : SEQ; g.M = g.NB * g.L; g.pos0 = gi ? PAST : 0; g.ksel = gi ? KSEL_S : KSEL_P; g.LK = gi ? PAST + DEC_SEQ : SEQ;
        const size_t M = g.M;
        g.Z = (float*)B.take(M * NIN * 4); g.F = (float*)B.take(M * 256 * 4); g.KK = (float*)B.take(M * 256 * 4); g.AQ = (float*)B.take(M * 512 * 4); g.QI = (float*)B.take(M * 256 * 4); g.WI = (float*)B.take(M * 8 * 4);
        g.OHG = (float*)B.take(M * 256 * 4); g.YCAT = (float*)B.take(M * D * 4); g.SC = (float*)B.take(M * g.LK * 4); g.SEL = (int*)B.take(M * TOPK * 4); g.NSEL = (int*)B.take(M * 4);
        g.P = (float*)B.take(M * NH * TOPK * 4); g.Y = (float*)B.take(M * D * 4); g.H1 = (float*)B.take(M * D * 4); g.H2 = (float*)B.take(M * D * 4); g.XO = (float*)B.take(M * D * 4);
        g.QX = (float*)B.take(M * XW * 4); g.PX = (float*)B.take(M * XH * NMEM * 4); g.OX = (float*)B.take(M * XW * 4); g.UU = (float*)B.take(M * DFF * 4);
        g.THR = nullptr; g.TIDX = nullptr; g.rope_c = rope_c; g.rope_s = rope_s; g.page_table = page_table; }
    if (B.used > ws_size) { R.fail("workspace too small"); return; }
    float* xmid[2] = {G[0].XO, G[1].XO};

    R.run(RopeTab{rope_c, rope_s}, (long)(SEQ + 8) * 32);
    R.run(LowerB{hg_lb_logits, lb}, 256);
    for (int l = 0; l < DEPTH; ++l) {
        float* mk = out + O_MKP + (size_t)l * BATCH * NMEM * XW; float* mv = out + O_MVP + (size_t)l * BATCH * NMEM * XW;
        R.gemm(GemmEl{mem_prompt, w_xk + (size_t)l * D * XW, mk, BATCH * NMEM, XW, D, 0});
        R.gemm(GemmEl{mem_prompt, w_xv + (size_t)l * D * XW, mv, BATCH * NMEM, XW, D, 0});
        for (int gi = 0; gi < 2; ++gi) { Grp g = G[gi]; const size_t M = g.M; g.layer = l;
            g.X = l == 0 ? (gi ? x_sample : x_prompt) : xmid[gi];
            g.XO = l == DEPTH - 1 ? out + (gi ? O_YS : O_YP) : xmid[gi];
            g.AK = out + (gi ? O_KS : O_KP) + (size_t)l * M * KVW; g.AV = out + (gi ? O_VS : O_VP) + (size_t)l * M * KVW; g.KI = out + (gi ? O_KIS : O_KIP) + (size_t)l * M * IDD;
            g.hg_state_out = out + (gi ? O_HGS : O_HGP) + (size_t)l * g.NB * HGH * 4096; g.hg_state_in = gi ? state_hgrn + (size_t)l * DEC_BATCH * HGH * 4096 : nullptr;
            g.conv_out = out + (gi ? O_CVS : O_CVP) + (size_t)l * g.NB * 2 * CONVD; g.conv_in = gi ? state_conv + (size_t)l * DEC_BATCH * 2 * CONVD : nullptr;
            g.cache_k = cache_k + (size_t)l * NPHYS * PAGE * KVW; g.cache_v = cache_v + (size_t)l * NPHYS * PAGE * KVW; g.cache_kidx = cache_kidx + (size_t)l * NPHYS * PAGE * IDD;
            g.MK = gi ? cache_mem_k + (size_t)l * DEC_BATCH * NMEM * XW : mk; g.MV = gi ? cache_mem_v + (size_t)l * DEC_BATCH * NMEM * XW : mv;
            g.w_conv = w_conv + (size_t)l * 3 * CONVD; g.lb = lb + l * 256; g.hg_norm = hg_norm + l * 256;
            g.ln1g = ln1_g + l * D; g.ln1b = ln1_b + l * D; g.ln2g = ln2_g + l * D; g.ln2b = ln2_b + l * D; g.ln3g = ln3_g + l * D; g.ln3b = ln3_b + l * D;
            R.gemm(GemmEl{g.X, w_in + (size_t)l * D * NIN, g.Z, g.M, NIN, D, 0});
            R.run(PostConv{g}, (long)M * CONVD);
            R.run(PostGate{g}, (long)M * HGW);
            R.run(PostRope{g}, (long)M * 792);
            R.run(HgrnSeq{g}, (long)g.NB * HGH * 64);
            R.run(HgrnNorm{g}, (long)M * HGW);
            R.run(IdxScore{g}, (long)M * g.LK);
            R.run(TopK{g}, (long)M);
            R.run(AttProb{g}, (long)M * NH);
            R.run(AttOut{g}, (long)M * 512);
            R.gemm(GemmEl{g.YCAT, w_out + (size_t)l * D * D, g.Y, g.M, D, D, 0});
            R.run(LnRes{g.X, g.Y, g.ln1g, g.ln1b, g.H1, g.M, 0}, (long)M);
            R.gemm(GemmEl{g.H1, w_xq + (size_t)l * D * XW, g.QX, g.M, XW, D, 0});
            R.run(XProb{g}, (long)M * XH);
            R.run(XOut{g}, (long)M * XW);
            R.gemm(GemmEl{g.OX, w_xo + (size_t)l * XW * D, g.Y, g.M, D, XW, 0});
            R.run(LnRes{g.H1, g.Y, g.ln2g, g.ln2b, g.H2, g.M, 0}, (long)M);
            R.gemm(GemmEl{g.H2, w_up + (size_t)l * D * DFF, g.UU, g.M, DFF, D, 1});
            R.gemm(GemmEl{g.UU, w_down + (size_t)l * DFF * D, g.Y, g.M, D, DFF, 0});
            R.run(LnRes{g.H2, g.Y, g.ln3g, g.ln3b, g.XO, g.M, 0}, (long)M);
        }
    }
}
}
template <class F> __global__ void __launch_bounds__(256) k_run(F f, long n) {
    for (long i = (long)blockIdx.x * blockDim.x + threadIdx.x; i < n; i += (long)gridDim.x * blockDim.x) f(i);
}
struct GpuRunner { hipStream_t stream;
    template <class F> void run(const F& f, long n) { long blocks = (n + 255) / 256; if (blocks > 262144) blocks = 262144; if (blocks < 1) blocks = 1; hipLaunchKernelGGL(k_run<F>, dim3((unsigned)blocks), dim3(256), 0, stream, f, n); }
    void gemm(const nb::GemmEl& g) { run(g, (long)g.M * g.N); }
    void fail(const char* m) { fprintf(stderr, "kernel_launch: %s\n", m); }
};
extern "C" void kernel_launch(void* const* d_in, const int* in_sizes, int n_in, void* d_out, int out_size, void* d_ws, size_t ws_size, hipStream_t stream) {
    if (n_in != 28 || (size_t)out_size != nb::O_END) { fprintf(stderr, "kernel_launch: unexpected shapes n_in=%d out=%d\n", n_in, out_size); return; }
    GpuRunner R{stream}; nb::forward(R, d_in, (float*)d_out, d_ws, ws_size);
}
```

```cpp
#include <hip/hip_runtime.h>
#include <cstdio>
#include <cstring>
#include <cmath>
#include <cstdint>
#include <cstddef>
#ifdef HOST_SIM
#define HD inline
#define HDF inline
#else
#define HD __device__ __forceinline__
#define HDF __host__ __device__ __forceinline__
#endif

#ifndef CFG_BATCH
#define CFG_BATCH 4
#endif
#ifndef CFG_SEQ
#define CFG_SEQ 4096
#endif
#ifndef CFG_DEC_BATCH
#define CFG_DEC_BATCH 32
#endif
#ifndef CFG_PAST
#define CFG_PAST 8192
#endif
namespace nb {
constexpr int D = 1024, DEPTH = 2, BATCH = CFG_BATCH, SEQ = CFG_SEQ, DEC_BATCH = CFG_DEC_BATCH, DEC_SEQ = 8, PAST = CFG_PAST, PAGE = 128;
constexpr int NPAGES = PAST / PAGE, NPHYS = (DEC_BATCH * NPAGES * 5) / 4;
constexpr int CONVD = 256, HGW = 256, HGH = 4, HDK = 64, ATTW = 512, HD_ = 64, NH = 8, NKV = 4, KVW = 256, IH = 8, IDD = 32, TOPK = 256;
constexpr int NIN = 3112;
constexpr int C_H = 0, C_B = 256, C_C = 512, G_Q = 768, G_F = 1024, G_I = 1280, G_G = 1536, A_Q = 1792, A_K = 2304, A_V = 2560, A_QI = 2816, A_KI = 3072, A_W = 3104;
constexpr int NMEM = 256, XH = 4, XHD = 128, XW = 512, DFF = 4096;
constexpr int MP = BATCH * SEQ, MS = DEC_BATCH * DEC_SEQ;
constexpr int KSEL_P = (SEQ / 4 < TOPK) ? SEQ / 4 : TOPK;
constexpr int KSEL_S = ((PAST + DEC_SEQ) / 4 < TOPK) ? (PAST + DEC_SEQ) / 4 : TOPK;
constexpr float LN_EPS = 1e-5f;
constexpr float DN_ALPHA = 1.41421356237309515f;
constexpr size_t O_YP = 0, O_YS = O_YP + (size_t)MP * D, O_KP = O_YS + (size_t)MS * D, O_VP = O_KP + (size_t)DEPTH * MP * KVW, O_KIP = O_VP + (size_t)DEPTH * MP * KVW,
                 O_KS = O_KIP + (size_t)DEPTH * MP * IDD, O_VS = O_KS + (size_t)DEPTH * MS * KVW, O_KIS = O_VS + (size_t)DEPTH * MS * KVW,
                 O_HGP = O_KIS + (size_t)DEPTH * MS * IDD, O_HGS = O_HGP + (size_t)DEPTH * BATCH * HGH * 4096, O_CVP = O_HGS + (size_t)DEPTH * DEC_BATCH * HGH * 4096,
                 O_CVS = O_CVP + (size_t)DEPTH * BATCH * 2 * CONVD, O_MKP = O_CVS + (size_t)DEPTH * DEC_BATCH * 2 * CONVD, O_MVP = O_MKP + (size_t)DEPTH * BATCH * NMEM * XW,
                 O_END = O_MVP + (size_t)DEPTH * BATCH * NMEM * XW;

struct Grp {
    int NB, L, M, pos0, ksel, is_sample, layer, LK;
    const float* X;
    float* Z;
    float* F;
    float* KK;
    float* AQ;
    float* AK;
    float* AV;
    float* QI;
    float* KI;
    float* WI;
    float* OHG;
    float* YCAT;
    float* SC;
    float* THR; int* TIDX; int* SEL; int* NSEL;
    float* P;
    float* Y;
    float* H1; float* H2; float* XO;
    float* QX;
    float* PX;
    float* OX;
    float* UU;
    const float* MK; const float* MV;
    float* hg_state_out; const float* hg_state_in;
    float* conv_out; const float* conv_in;
    const float *cache_k, *cache_v, *cache_kidx; const int* page_table;
    const float* rope_c; const float* rope_s;
    const float *w_conv, *lb, *hg_norm, *ln1g, *ln1b, *ln2g, *ln2b, *ln3g, *ln3b;
};

HD float sigmoidf_(float x) { return 1.0f / (1.0f + expf(-x)); }

struct GemmEl { const float* A; const float* W; float* C; int M, N, K; int act;
    HD void operator()(long i) const { const int row = (int)(i / N), col = (int)(i % N); const float* a = A + (size_t)row * K; float acc = 0.f;
        for (int k = 0; k < K; ++k) acc = fmaf(a[k], W[(size_t)k * N + col], acc);
        if (act == 1) { acc = acc > 0.f ? acc : 0.f; acc = acc * acc; }
        C[(size_t)row * N + col] = acc; } };

struct RopeTab { float* c; float* s;
    HD void operator()(long i) const { const int p = (int)(i / 32), j = (int)(i % 32); const double pos = p < SEQ ? (double)p : (double)(PAST + (p - SEQ));
        const double inv = pow(10000.0, -(double)j / 32.0), ang = pos * inv; c[i] = (float)cos(ang); s[i] = (float)sin(ang); } };

struct LowerB { const float* logits; float* lb;
    HD void operator()(long i) const { const int c = (int)i; const float l0 = logits[c], l1 = logits[256 + c]; const float m = l0 > l1 ? l0 : l1;
        const float e0 = expf(l0 - m), e1 = expf(l1 - m); lb[c] = 0.f; lb[256 + c] = e1 / (e0 + e1); } };

struct PostConv { Grp g;
    HD float u(int b, int t, int c) const { if (t >= 0) { const float* z = g.Z + (size_t)(b * g.L + t) * NIN; return z[C_C + c] * z[C_H + c]; }
        return g.conv_in ? g.conv_in[((size_t)b * 2 + (t + 2)) * CONVD + c] : 0.f; }
    HD void operator()(long i) const { const int row = (int)(i / CONVD), c = (int)(i % CONVD), b = row / g.L, t = row % g.L;
        const float y = g.w_conv[0 * CONVD + c] * u(b, t - 2, c) + g.w_conv[1 * CONVD + c] * u(b, t - 1, c) + g.w_conv[2 * CONVD + c] * u(b, t, c);
        g.YCAT[(size_t)row * D + c] = g.Z[(size_t)row * NIN + C_B + c] * y;
        if (t >= g.L - 2) g.conv_out[((size_t)b * 2 + (t - (g.L - 2))) * CONVD + c] = u(b, t, c); } };

struct PostGate { Grp g;
    HD void operator()(long i) const { const int row = (int)(i / HGW), c = (int)(i % HGW); const float sg = sigmoidf_(g.Z[(size_t)row * NIN + G_F + c]); const float lb = g.lb[c];
        g.F[i] = lb + (1.f - lb) * sg; g.KK[i] = (1.f - lb) * (1.f - sg); } };

struct PostRope { Grp g;
    HD void operator()(long i) const { const int row = (int)(i / 792); int p = (int)(i % 792); const int t = row % g.L; const float* z = g.Z + (size_t)row * NIN;
        const float* rc = g.rope_c + (size_t)((g.is_sample ? SEQ : 0) + t) * 32; const float* rs = g.rope_s + (size_t)((g.is_sample ? SEQ : 0) + t) * 32;
        if (p < 256) { const int h = p / 32, j = p % 32; const float x1 = z[A_Q + h * 64 + j], x2 = z[A_Q + h * 64 + 32 + j], c = rc[j], s = rs[j];
            g.AQ[(size_t)row * 512 + h * 64 + j] = x1 * c - x2 * s; g.AQ[(size_t)row * 512 + h * 64 + 32 + j] = x2 * c + x1 * s; return; } p -= 256;
        if (p < 128) { const int h = p / 32, j = p % 32; const float x1 = z[A_K + h * 64 + j], x2 = z[A_K + h * 64 + 32 + j], c = rc[j], s = rs[j];
            g.AK[(size_t)row * 256 + h * 64 + j] = x1 * c - x2 * s; g.AK[(size_t)row * 256 + h * 64 + 32 + j] = x2 * c + x1 * s; return; } p -= 128;
        if (p < 256) { g.AV[(size_t)row * 256 + p] = z[A_V + p]; return; } p -= 256;
        if (p < 128) { const int h = p / 16, j = p % 16; const float x1 = z[A_QI + h * 32 + j], x2 = z[A_QI + h * 32 + 16 + j], c = rc[2 * j], s = rs[2 * j]; const float sc = 0.17677669529663687f;
            g.QI[(size_t)row * 256 + h * 32 + j] = (x1 * c - x2 * s) * sc; g.QI[(size_t)row * 256 + h * 32 + 16 + j] = (x2 * c + x1 * s) * sc; return; } p -= 128;
        if (p < 16) { const int j = p; const float x1 = z[A_KI + j], x2 = z[A_KI + 16 + j], c = rc[2 * j], s = rs[2 * j];
            g.KI[(size_t)row * 32 + j] = x1 * c - x2 * s; g.KI[(size_t)row * 32 + 16 + j] = x2 * c + x1 * s; return; } p -= 16;
        g.WI[(size_t)row * 8 + p] = z[A_W + p] * 0.35355339059327373f; } };

struct HgrnSeq { Grp g;
    HD void operator()(long i) const { const int v = (int)(i % 64), h = (int)((i / 64) % HGH), b = (int)(i / (64 * HGH)); float S[64];
#pragma unroll
        for (int k = 0; k < 64; ++k) S[k] = g.hg_state_in ? g.hg_state_in[(((size_t)b * HGH + h) * 64 + k) * 64 + v] : 0.f;
        for (int t = 0; t < g.L; ++t) { const size_t row = (size_t)b * g.L + t; const float* z = g.Z + row * NIN; const float* f = g.F + row * HGW + h * 64; const float* kk = g.KK + row * HGW + h * 64; const float vv = z[G_I + h * 64 + v]; float o = 0.f;
#pragma unroll
            for (int k = 0; k < 64; ++k) { S[k] = f[k] * S[k] + kk[k] * vv; o = fmaf(z[G_Q + h * 64 + k], S[k], o); }
            g.OHG[row * HGW + h * 64 + v] = o; }
#pragma unroll
        for (int k = 0; k < 64; ++k) g.hg_state_out[(((size_t)b * HGH + h) * 64 + k) * 64 + v] = S[k]; } };

struct HgrnNorm { Grp g;
    HD void operator()(long i) const { const int row = (int)(i / HGW), c = (int)(i % HGW), h = c / 64; const float* o = g.OHG + (size_t)row * HGW + h * 64; float ss = 0.f;
        for (int k = 0; k < 64; ++k) ss = fmaf(o[k], o[k], ss);
        const float r = 1.0f / sqrtf(ss * (1.f / 64.f) + LN_EPS);
        g.YCAT[(size_t)row * D + 256 + c] = o[c % 64] * r * g.hg_norm[c] * sigmoidf_(g.Z[(size_t)row * NIN + G_G + c]); } };

HD const float* ki_row(const Grp& g, int b, int s) {
    if (!g.is_sample) return g.KI + ((size_t)b * g.L + s) * IDD;
    if (s < PAST) { const int pg = g.page_table[b * NPAGES + s / PAGE]; return g.cache_kidx + ((size_t)pg * PAGE + s % PAGE) * IDD; }
    return g.KI + ((size_t)b * g.L + (s - PAST)) * IDD; }
HD const float* k_row(const Grp& g, int b, int s) {
    if (!g.is_sample) return g.AK + ((size_t)b * g.L + s) * KVW;
    if (s < PAST) { const int pg = g.page_table[b * NPAGES + s / PAGE]; return g.cache_k + ((size_t)pg * PAGE + s % PAGE) * KVW; }
    return g.AK + ((size_t)b * g.L + (s - PAST)) * KVW; }
HD const float* v_row(const Grp& g, int b, int s) {
    if (!g.is_sample) return g.AV + ((size_t)b * g.L + s) * KVW;
    if (s < PAST) { const int pg = g.page_table[b * NPAGES + s / PAGE]; return g.cache_v + ((size_t)pg * PAGE + s % PAGE) * KVW; }
    return g.AV + ((size_t)b * g.L + (s - PAST)) * KVW; }

struct IdxScore { Grp g;
    HD void operator()(long i) const { const int row = (int)(i / g.LK), s = (int)(i % g.LK), b = row / g.L, t = row % g.L; const int qpos = g.pos0 + t;
        if (s > qpos) return;
        const float* k = ki_row(g, b, s); const float* q = g.QI + (size_t)row * 256; const float* w = g.WI + (size_t)row * 8; float sc = 0.f;
        for (int h = 0; h < IH; ++h) { float d = 0.f; for (int e = 0; e < IDD; ++e) d = fmaf(q[h * IDD + e], k[e], d); sc = fmaf(w[h], d > 0.f ? d : 0.f, sc); }
        g.SC[(size_t)row * g.LK + s] = sc; } };

HD unsigned fkey(float x) { unsigned u; if (x == 0.f) x = 0.f;
#ifdef HOST_SIM
    __builtin_memcpy(&u, &x, 4);
#else
    u = __float_as_uint(x);
#endif
    if (u == 0x80000000u) u = 0u; return (u & 0x80000000u) ? ~u : (u | 0x80000000u); }
HD float fkey_inv(unsigned k) { unsigned u = (k & 0x80000000u) ? (k & 0x7fffffffu) : ~k; float x;
#ifdef HOST_SIM
    __builtin_memcpy(&x, &u, 4);
#else
    x = __uint_as_float(u);
#endif
    return x; }

struct TopK { Grp g;
    HD void operator()(long i) const { const int row = (int)i, t = row % g.L; const int nv = g.pos0 + t + 1; const float* sc = g.SC + (size_t)row * g.LK; int* sel = g.SEL + (size_t)row * TOPK;
        if (nv <= g.ksel) { for (int s = 0; s < nv; ++s) sel[s] = s; g.NSEL[row] = nv; return; }
        unsigned K = 0u;
        for (int bit = 31; bit >= 0; --bit) { const unsigned cand = K | (1u << bit); int cnt = 0; for (int s = 0; s < nv; ++s) cnt += (fkey(sc[s]) >= cand) ? 1 : 0; if (cnt >= g.ksel) K = cand; }
        int cgt = 0; for (int s = 0; s < nv; ++s) cgt += (fkey(sc[s]) > K) ? 1 : 0;
        int r = g.ksel - cgt, n = 0;
        for (int s = 0; s < nv; ++s) { const unsigned k = fkey(sc[s]); if (k > K) sel[n++] = s; else if (k == K && r > 0) { sel[n++] = s; --r; } }
        g.NSEL[row] = n; } };

struct AttProb { Grp g;
    HD void operator()(long i) const { const int row = (int)(i / NH), h = (int)(i % NH), b = row / g.L, n = h / 2; const int ns = g.NSEL[row]; const int* sel = g.SEL + (size_t)row * TOPK;
        float* p = g.P + ((size_t)row * NH + h) * TOPK; const float* q = g.AQ + (size_t)row * 512 + h * 64; float mx = -INFINITY;
        for (int j = 0; j < ns; ++j) { const float* k = k_row(g, b, sel[j]) + n * 64; float d = 0.f; for (int e = 0; e < 64; ++e) d = fmaf(q[e], k[e], d); d *= 0.125f; p[j] = d; mx = d > mx ? d : mx; }
        float sum = 0.f; for (int j = 0; j < ns; ++j) { const float e = expf(p[j] - mx); p[j] = e; sum += e; }
        const float inv = 1.f / sum; for (int j = 0; j < ns; ++j) p[j] *= inv; } };

struct AttOut { Grp g;
    HD void operator()(long i) const { const int row = (int)(i / 512), c = (int)(i % 512), h = c / 64, d = c % 64, b = row / g.L, n = h / 2; const int ns = g.NSEL[row]; const int* sel = g.SEL + (size_t)row * TOPK;
        const float* p = g.P + ((size_t)row * NH + h) * TOPK; float o = 0.f;
        for (int j = 0; j < ns; ++j) o = fmaf(p[j], v_row(g, b, sel[j])[n * 64 + d], o);
        g.YCAT[(size_t)row * D + 512 + c] = o; } };

struct LnRes { const float* base; const float* y; const float* gam; const float* bet; float* out; int M, pad;
    HD void operator()(long i) const { const size_t o = (size_t)i * D; float s = 0.f; for (int c = 0; c < D; ++c) s += DN_ALPHA * base[o + c] + y[o + c];
        const float mu = s * (1.f / D); float q = 0.f; for (int c = 0; c < D; ++c) { const float d = DN_ALPHA * base[o + c] + y[o + c] - mu; q = fmaf(d, d, q); }
        const float r = 1.0f / sqrtf(q * (1.f / D) + LN_EPS); for (int c = 0; c < D; ++c) out[o + c] = (DN_ALPHA * base[o + c] + y[o + c] - mu) * r * gam[c] + bet[c]; } };

struct XProb { Grp g;
    HD void operator()(long i) const { const int row = (int)(i / XH), h = (int)(i % XH), b = row / g.L; const float* q = g.QX + (size_t)row * XW + h * XHD; float* p = g.PX + ((size_t)row * XH + h) * NMEM; float mx = -INFINITY;
        for (int m = 0; m < NMEM; ++m) { const float* k = g.MK + ((size_t)b * NMEM + m) * XW + h * XHD; float d = 0.f; for (int e = 0; e < XHD; ++e) d = fmaf(q[e], k[e], d); d *= 0.08838834764831845f; p[m] = d; mx = d > mx ? d : mx; }
        float sum = 0.f; for (int m = 0; m < NMEM; ++m) { const float e = expf(p[m] - mx); p[m] = e; sum += e; }
        const float inv = 1.f / sum; for (int m = 0; m < NMEM; ++m) p[m] *= inv; } };

struct XOut { Grp g;
    HD void operator()(long i) const { const int row = (int)(i / XW), c = (int)(i % XW), h = c / XHD, b = row / g.L; const float* p = g.PX + ((size_t)row * XH + h) * NMEM; float o = 0.f;
        for (int m = 0; m < NMEM; ++m) o = fmaf(p[m], g.MV[((size_t)b * NMEM + m) * XW + c], o);
        g.OX[(size_t)row * XW + c] = o; } };

struct CopyF { const float* src; float* dst; HD void operator()(long i) const { dst[i] = src[i]; } };
}
#define XB_TMO      128
#define XB_XCNT(j)  (256  + 64 * (j))
#define XB_XSUB(j)  (1280 + 64 * (j))
#define XB_XGEN(j)  (2304 + 64 * (j))
#define XB_TOP      3328
#define XB_TOPGEN   3392
#define XCD_BAR_WORDS 3456
#ifndef XB_SPIN_CAP
#define XB_SPIN_CAP (1u << 22)
#endif
#define LAS __attribute__((address_space(3)))
__device__ __forceinline__ unsigned xb_ld(unsigned* p)              { return __hip_atomic_load(p, __ATOMIC_RELAXED, __HIP_MEMORY_SCOPE_AGENT); }
__device__ __forceinline__ unsigned xb_add(unsigned* p, unsigned v) { return __hip_atomic_fetch_add(p, v, __ATOMIC_RELAXED, __HIP_MEMORY_SCOPE_AGENT); }
__device__ __forceinline__ unsigned xb_xcc_id() { return (unsigned)__builtin_amdgcn_s_getreg((3 << 11) | 20) & 0xFu; }
#define XB_SPIN(cond, bar) do { unsigned _sp = 0; while (cond) { __builtin_amdgcn_s_sleep(1); \
    if ((++_sp & 255u) == 0u) { if (xb_ld(&(bar)[XB_TMO])) break; if (_sp > XB_SPIN_CAP) { atomicAdd(&(bar)[XB_TMO], 1u); break; } } } } while (0)
struct XcdBarrier { unsigned* bar; unsigned x; volatile LAS unsigned* st; };
__device__ __forceinline__ XcdBarrier xcd_barrier_post(unsigned* bar, volatile LAS unsigned* st) {
    XcdBarrier b; b.bar = bar; b.x = xb_xcc_id(); b.st = st;
    if (threadIdx.x == 0) (void)xb_add(&bar[XB_XCNT(b.x)], 1u);
    return b;
}
__device__ __forceinline__ void xcd_barrier_complete(unsigned* bar, unsigned x, unsigned& nloc, unsigned& nx) {
    const unsigned G = gridDim.x * gridDim.y * gridDim.z;
    unsigned sum, cnt, mine, sp = 0u;
    for (;;) {
        sum = 0u; cnt = 0u; mine = 0u;
#pragma unroll
        for (unsigned j = 0; j < 16; ++j) { const unsigned c = xb_ld(&bar[XB_XCNT(j)]); sum += c; cnt += (c > 0u) ? 1u : 0u; mine = (j == x) ? c : mine; }
        if (sum == G) break;
        __builtin_amdgcn_s_sleep(1);
        if ((++sp & 255u) == 0u) { if (xb_ld(&bar[XB_TMO])) break; if (sp > XB_SPIN_CAP) { atomicAdd(&bar[XB_TMO], 1u); break; } }
    }
    nloc = mine > 0u ? mine : 1u; nx = cnt > 0u ? cnt : 1u;
}
__device__ __forceinline__ void xcd_barrier(const XcdBarrier& b) {
    asm volatile("s_waitcnt vmcnt(0)" ::: "memory");
    __syncthreads();
    if (threadIdx.x == 0) {
        unsigned* bar = b.bar;
        __builtin_amdgcn_s_waitcnt(0);
        unsigned nloc = b.st[0], nx = b.st[1];
        if (nloc == 0u) { xcd_barrier_complete(bar, b.x, nloc, nx); b.st[0] = nloc; b.st[1] = nx; }
        const unsigned old = xb_add(&bar[XB_XSUB(b.x)], 1u);
        const unsigned gen = old / nloc;
        if (old + 1u == (gen + 1u) * nloc) {
            __builtin_amdgcn_fence(__ATOMIC_RELEASE, "agent");
            asm volatile("s_waitcnt vmcnt(0)" ::: "memory");
            const unsigned og = xb_add(&bar[XB_TOP], 1u);
            const unsigned tg = og / nx;
            if (og + 1u == (tg + 1u) * nx) xb_add(&bar[XB_TOPGEN], 1u);
            else XB_SPIN(xb_ld(&bar[XB_TOPGEN]) == tg, bar);
            __builtin_amdgcn_fence(__ATOMIC_ACQUIRE, "agent");
            xb_add(&bar[XB_XGEN(b.x)], 1u);
            asm volatile("s_waitcnt vmcnt(0)" ::: "memory");
        } else {
            XB_SPIN(xb_ld(&bar[XB_XGEN(b.x)]) == gen, bar);
            __builtin_amdgcn_fence(__ATOMIC_ACQUIRE, "agent");
            asm volatile("s_waitcnt vmcnt(0)" ::: "memory");
        }
    }
    __syncthreads();
}
#include <cstring>
namespace nb {
struct Io { const float *x_prompt, *x_sample, *cache_k, *cache_v, *cache_kidx, *state_hgrn, *state_conv, *cache_mem_k, *cache_mem_v; const int* page_table; const float *mem_prompt, *w_in, *w_conv, *hg_lb_logits, *hg_norm,
            *w_out, *ln1_g, *ln1_b, *w_xq, *w_xk, *w_xv, *w_xo, *ln2_g, *ln2_b, *w_up, *w_down, *ln3_g, *ln3_b; float* out; char* ws; size_t ws_size; };
HDF Io make_io(void* const* d_in, float* out, void* ws, size_t ws_size) { Io io;
    io.x_prompt = (const float*)d_in[0]; io.x_sample = (const float*)d_in[1]; io.cache_k = (const float*)d_in[2]; io.cache_v = (const float*)d_in[3]; io.cache_kidx = (const float*)d_in[4];
    io.state_hgrn = (const float*)d_in[5]; io.state_conv = (const float*)d_in[6]; io.cache_mem_k = (const float*)d_in[7]; io.cache_mem_v = (const float*)d_in[8]; io.page_table = (const int*)d_in[9];
    io.mem_prompt = (const float*)d_in[10]; io.w_in = (const float*)d_in[11]; io.w_conv = (const float*)d_in[12]; io.hg_lb_logits = (const float*)d_in[13]; io.hg_norm = (const float*)d_in[14];
    io.w_out = (const float*)d_in[15]; io.ln1_g = (const float*)d_in[16]; io.ln1_b = (const float*)d_in[17]; io.w_xq = (const float*)d_in[18]; io.w_xk = (const float*)d_in[19]; io.w_xv = (const float*)d_in[20];
    io.w_xo = (const float*)d_in[21]; io.ln2_g = (const float*)d_in[22]; io.ln2_b = (const float*)d_in[23]; io.w_up = (const float*)d_in[24]; io.w_down = (const float*)d_in[25]; io.ln3_g = (const float*)d_in[26];
    io.ln3_b = (const float*)d_in[27]; io.out = out; io.ws = (char*)ws; io.ws_size = ws_size; return io; }
struct Bump { char* p; size_t used; HDF void* take(size_t bytes) { void* r = p + used; used += (bytes + 255) & ~(size_t)255; return r; } };
struct Shared { float *rope_c, *rope_s, *lb; };
HDF void alloc_grp(Grp& g, Bump& B, int gi) {
    g.is_sample = gi; g.NB = gi ? DEC_BATCH : BATCH; g.L = gi ? DEC_SEQ : SEQ; g.M = g.NB * g.L; g.pos0 = gi ? PAST : 0; g.ksel = gi ? KSEL_S : KSEL_P; g.LK = gi ? PAST + DEC_SEQ : SEQ; g.layer = 0;
    const size_t M = g.M;
    g.Z = (float*)B.take(M * NIN * 4); g.F = (float*)B.take(M * 256 * 4); g.KK = (float*)B.take(M * 256 * 4); g.AQ = (float*)B.take(M * 512 * 4); g.QI = (float*)B.take(M * 256 * 4); g.WI = (float*)B.take(M * 8 * 4);
    g.OHG = (float*)B.take(M * 256 * 4); g.YCAT = (float*)B.take(M * D * 4); g.SC = (float*)B.take(M * g.LK * 4); g.SEL = (int*)B.take(M * TOPK * 4); g.NSEL = (int*)B.take(M * 4);
    g.P = (float*)B.take(M * NH * TOPK * 4); g.Y = (float*)B.take(M * D * 4); g.H1 = (float*)B.take(M * D * 4); g.H2 = (float*)B.take(M * D * 4); g.XO = (float*)B.take(M * D * 4);
    g.QX = (float*)B.take(M * XW * 4); g.PX = (float*)B.take(M * XH * NMEM * 4); g.OX = (float*)B.take(M * XW * 4); g.UU = (float*)B.take(M * DFF * 4);
    g.THR = nullptr; g.TIDX = nullptr; }
HDF Grp build_grp(const Io& io, int l, int gi, Shared& sh, size_t& used) {
    Bump B{io.ws, 0}; sh.rope_c = (float*)B.take((size_t)(SEQ + 8) * 32 * 4); sh.rope_s = (float*)B.take((size_t)(SEQ + 8) * 32 * 4); sh.lb = (float*)B.take(DEPTH * 256 * 4);
    Grp g0, g1; alloc_grp(g0, B, 0); alloc_grp(g1, B, 1); used = B.used;
    Grp g = gi ? g1 : g0; float* xmid = g.XO; float* out = io.out; const size_t M = g.M; g.layer = l;
    g.rope_c = sh.rope_c; g.rope_s = sh.rope_s; g.page_table = io.page_table;
    g.X = l == 0 ? (gi ? io.x_sample : io.x_prompt) : xmid;
    g.XO = l == DEPTH - 1 ? out + (gi ? O_YS : O_YP) : xmid;
    g.AK = out + (gi ? O_KS : O_KP) + (size_t)l * M * KVW; g.AV = out + (gi ? O_VS : O_VP) + (size_t)l * M * KVW; g.KI = out + (gi ? O_KIS : O_KIP) + (size_t)l * M * IDD;
    g.hg_state_out = out + (gi ? O_HGS : O_HGP) + (size_t)l * g.NB * HGH * 4096; g.hg_state_in = gi ? io.state_hgrn + (size_t)l * DEC_BATCH * HGH * 4096 : nullptr;
    g.conv_out = out + (gi ? O_CVS : O_CVP) + (size_t)l * g.NB * 2 * CONVD; g.conv_in = gi ? io.state_conv + (size_t)l * DEC_BATCH * 2 * CONVD : nullptr;
    g.cache_k = io.cache_k + (size_t)l * NPHYS * PAGE * KVW; g.cache_v = io.cache_v + (size_t)l * NPHYS * PAGE * KVW; g.cache_kidx = io.cache_kidx + (size_t)l * NPHYS * PAGE * IDD;
    float* mk = out + O_MKP + (size_t)l * BATCH * NMEM * XW; float* mv = out + O_MVP + (size_t)l * BATCH * NMEM * XW;
    g.MK = gi ? io.cache_mem_k + (size_t)l * DEC_BATCH * NMEM * XW : mk; g.MV = gi ? io.cache_mem_v + (size_t)l * DEC_BATCH * NMEM * XW : mv;
    g.w_conv = io.w_conv + (size_t)l * 3 * CONVD; g.lb = sh.lb + l * 256; g.hg_norm = io.hg_norm + l * 256;
    g.ln1g = io.ln1_g + l * D; g.ln1b = io.ln1_b + l * D; g.ln2g = io.ln2_g + l * D; g.ln2b = io.ln2_b + l * D; g.ln3g = io.ln3_g + l * D; g.ln3b = io.ln3_b + l * D;
    return g; }

template <int L_, int GI, class Runner> HDF void layer_group(Runner& R, const Io& io) {
    Shared sh; size_t used; const Grp g = build_grp(io, L_, GI, sh, used); const size_t M = g.M; const int l = L_;
    R.gemm(GemmEl{g.X, io.w_in + (size_t)l * D * NIN, g.Z, g.M, NIN, D, 0});
    R.run(PostConv{g}, (long)M * CONVD);
    R.run(PostGate{g}, (long)M * HGW);
    R.run(PostRope{g}, (long)M * 792);
    R.run(HgrnSeq{g}, (long)g.NB * HGH * 64);
    R.run(HgrnNorm{g}, (long)M * HGW);
    R.run(IdxScore{g}, (long)M * g.LK);
    R.run(TopK{g}, (long)M);
    R.run(AttProb{g}, (long)M * NH);
    R.run(AttOut{g}, (long)M * 512);
    R.gemm(GemmEl{g.YCAT, io.w_out + (size_t)l * D * D, g.Y, g.M, D, D, 0});
    R.run(LnRes{g.X, g.Y, g.ln1g, g.ln1b, g.H1, g.M, 0}, (long)M);
    R.gemm(GemmEl{g.H1, io.w_xq + (size_t)l * D * XW, g.QX, g.M, XW, D, 0});
    R.run(XProb{g}, (long)M * XH);
    R.run(XOut{g}, (long)M * XW);
    R.gemm(GemmEl{g.OX, io.w_xo + (size_t)l * XW * D, g.Y, g.M, D, XW, 0});
    R.run(LnRes{g.H1, g.Y, g.ln2g, g.ln2b, g.H2, g.M, 0}, (long)M);
    R.gemm(GemmEl{g.H2, io.w_up + (size_t)l * D * DFF, g.UU, g.M, DFF, D, 1});
    R.gemm(GemmEl{g.UU, io.w_down + (size_t)l * DFF * D, g.Y, g.M, D, DFF, 0});
    R.run(LnRes{g.H2, g.Y, g.ln3g, g.ln3b, g.XO, g.M, 0}, (long)M);
}
template <int L_, class Runner> HDF void layer(Runner& R, const Io& io) {
    float* mk = io.out + O_MKP + (size_t)L_ * BATCH * NMEM * XW; float* mv = io.out + O_MVP + (size_t)L_ * BATCH * NMEM * XW;
    R.gemm(GemmEl{io.mem_prompt, io.w_xk + (size_t)L_ * D * XW, mk, BATCH * NMEM, XW, D, 0});
    R.gemm(GemmEl{io.mem_prompt, io.w_xv + (size_t)L_ * D * XW, mv, BATCH * NMEM, XW, D, 0});
    layer_group<L_, 0>(R, io); layer_group<L_, 1>(R, io);
}
template <class Runner> HDF void forward(Runner& R, const Io& io) {
    Shared sh; size_t used; (void)build_grp(io, 0, 0, sh, used);
    if (used > io.ws_size) { R.fail("workspace too small"); return; }
    R.run(RopeTab{sh.rope_c, sh.rope_s}, (long)(SEQ + 8) * 32);
    R.run(LowerB{io.hg_lb_logits, sh.lb}, 256);
    layer<0>(R, io); layer<1>(R, io);
}
}
constexpr int MK_THREADS = 512, MK_LDS_BYTES = 147456, CTL_BYTES = 65536;
struct DevRunner { XcdBarrier bar; long gtid, gsize;
    template <class F> __device__ __forceinline__ void run(const F& f, long n) { for (long i = gtid; i < n; i += gsize) f(i); xcd_barrier(bar); }
    __device__ __forceinline__ void gemm(const nb::GemmEl& g) { run(g, (long)g.M * g.N); }
    __device__ __forceinline__ void fail(const char*) {}
};
struct MegaArgs { nb::Io io; unsigned* bar; };
__global__ void __launch_bounds__(MK_THREADS, 2) mega_fwd(MegaArgs a) {
    extern __shared__ __attribute__((aligned(16))) unsigned char lds[];
    volatile LAS unsigned* MISC = (volatile LAS unsigned*)((LAS unsigned char*)lds);
    if (threadIdx.x < 4) MISC[threadIdx.x] = 0u;
    __syncthreads();
    DevRunner R; R.bar = xcd_barrier_post(a.bar, MISC); R.gtid = (long)blockIdx.x * MK_THREADS + threadIdx.x; R.gsize = (long)gridDim.x * MK_THREADS;
    nb::forward(R, a.io);
}
extern "C" void kernel_launch(void* const* d_in, const int* in_sizes, int n_in, void* d_out, int out_size, void* d_ws, size_t ws_size, hipStream_t stream) {
    if (n_in != 28 || (size_t)out_size != nb::O_END) { fprintf(stderr, "kernel_launch: unexpected shapes n_in=%d out=%d\n", n_in, out_size); return; }
    static int grid = 0;
    if (grid == 0) { int dev = 0, cus = 0;
        if (hipGetDevice(&dev) != hipSuccess || hipDeviceGetAttribute(&cus, hipDeviceAttributeMultiprocessorCount, dev) != hipSuccess) { fprintf(stderr, "kernel_launch: device query failed\n"); grid = -1; return; }
        if (hipFuncSetAttribute((const void*)mega_fwd, hipFuncAttributeMaxDynamicSharedMemorySize, MK_LDS_BYTES) != hipSuccess) { fprintf(stderr, "kernel_launch: hipFuncSetAttribute failed\n"); grid = -1; return; }
        int per_cu = 0; (void)hipOccupancyMaxActiveBlocksPerMultiprocessor(&per_cu, (const void*)mega_fwd, MK_THREADS, MK_LDS_BYTES); (void)hipGetLastError();
        if (per_cu < 1) fprintf(stderr, "kernel_launch: occupancy query says %d\n", per_cu);
        grid = cus; }
    if (grid < 0) return;
    (void)hipMemsetAsync(d_ws, 0, CTL_BYTES, stream);
    MegaArgs a{}; a.io = nb::make_io(d_in, (float*)d_out, (char*)d_ws + CTL_BYTES, ws_size - CTL_BYTES); a.bar = (unsigned*)d_ws;
    hipLaunchKernelGGL(mega_fwd, dim3(grid), dim3(MK_THREADS), MK_LDS_BYTES, stream, a);
}
```
